# Optimizing an MI355X kernel written in HIP

```python
import jax, jax.numpy as jnp
from jax import lax
import numpy as np

D_MODEL = 1024
BATCH = 1
SEQ = 16384
DEPTH = 1

W_A = 3 * D_MODEL // 2
CONV_K = 3
CHUNK = 128
DH_B = 128
H_B = D_MODEL // DH_B
W_B = H_B * DH_B
D_FF = 4 * D_MODEL
N_PROJ = 3 * W_A + 2 * W_B + 2 * D_MODEL
LN_EPS = 1e-5
ALPHA = (2.0 * DEPTH) ** 0.25
BETA = (8.0 * DEPTH) ** -0.25

OFF_BA = 0
OFF_CA = OFF_BA + W_A
OFF_HA = OFF_CA + W_A
OFF_UB = OFF_HA + W_A
OFF_VB = OFF_UB + W_B
OFF_GA = OFF_VB + W_B
OFF_GB = OFF_GA + D_MODEL

kernel_name = "hybrid_shortconv_gmlp_deepnorm_encoder"


def _layernorm(x, g, b):
    xf = x.astype(jnp.float32)
    mu = jnp.mean(xf, axis=-1, keepdims=True)
    var = jnp.mean(jnp.square(xf - mu), axis=-1, keepdims=True)
    y = (xf - mu) * lax.rsqrt(var + LN_EPS) * g.astype(jnp.float32) + b.astype(jnp.float32)
    return y.astype(x.dtype)


def _centred_depthwise_conv(h, w):
    hp = jnp.pad(h, ((0, 0), (1, 1), (0, 0)))
    return hp[:, :-2, :] * w[0] + hp[:, 1:-1, :] * w[1] + hp[:, 2:, :] * w[2]


def _spatial_gate(u, v, g, b, w_s, b_s):
    bsz = v.shape[0]
    s = v.shape[1]
    n_chunks = s // CHUNK
    v = _layernorm(v, g, b)
    vc = v.reshape(bsz, n_chunks, CHUNK, H_B, DH_B)
    mixed = jnp.einsum('hij,bcjhd->bcihd', w_s, vc)
    mixed = mixed + jnp.transpose(b_s)[None, None, :, :, None]
    return u * mixed.reshape(bsz, s, W_B)


def setup_inputs(seed: int = 0) -> dict:
    key = jax.random.key(seed)
    ks = jax.random.split(key, 20)
    L = DEPTH

    def nrm(k, shape, scale):
        return jax.random.normal(k, shape, jnp.float32) * scale

    return {
        "x": nrm(ks[0], (BATCH, SEQ, D_MODEL), 1.0),
        "w_in": nrm(ks[1], (L, D_MODEL, N_PROJ), D_MODEL ** -0.5),
        "b_gate": nrm(ks[2], (L, 2 * D_MODEL), 0.02),
        "conv_w": nrm(ks[3], (L, CONV_K, W_A), CONV_K ** -0.5),
        "v_norm_g": 1.0 + nrm(ks[4], (L, W_B), 0.02),
        "v_norm_b": nrm(ks[5], (L, W_B), 0.02),
        "w_s": nrm(ks[6], (L, H_B, CHUNK, CHUNK), CHUNK ** -0.5),
        "b_s": 1.0 + nrm(ks[7], (L, H_B, CHUNK), 0.02),
        "w_pa": nrm(ks[8], (L, W_A, D_MODEL), W_A ** -0.5),
        "w_pb": nrm(ks[9], (L, W_B, D_MODEL), W_B ** -0.5),
        "w_o": nrm(ks[10], (L, D_MODEL, D_MODEL), BETA * D_MODEL ** -0.5),
        "ln1_g": 1.0 + nrm(ks[11], (L, D_MODEL), 0.02),
        "ln1_b": nrm(ks[12], (L, D_MODEL), 0.02),
        "w_ff1": nrm(ks[13], (L, D_MODEL, D_FF), BETA * D_MODEL ** -0.5),
        "w_ff2": nrm(ks[14], (L, D_FF, D_MODEL), BETA * D_FF ** -0.5),
        "ln2_g": 1.0 + nrm(ks[15], (L, D_MODEL), 0.02),
        "ln2_b": nrm(ks[16], (L, D_MODEL), 0.02),
    }


def reference(x, w_in, b_gate, conv_w, v_norm_g, v_norm_b, w_s, b_s, w_pa, w_pb, w_o,
              ln1_g, ln1_b, w_ff1, w_ff2, ln2_g, ln2_b):
    for l in range(DEPTH):
        p = jnp.einsum('bsd,dn->bsn', x, w_in[l])
        b_a = p[:, :, OFF_BA:OFF_CA]
        c_a = p[:, :, OFF_CA:OFF_HA]
        h_a = p[:, :, OFF_HA:OFF_UB]
        u_b = p[:, :, OFF_UB:OFF_VB]
        v_b = p[:, :, OFF_VB:OFF_GA]
        gates = jax.nn.sigmoid(p[:, :, OFF_GA:N_PROJ] + b_gate[l])
        g_a = gates[:, :, :D_MODEL]
        g_b = gates[:, :, D_MODEL:]
        a = b_a * _centred_depthwise_conv(c_a * h_a, conv_w[l])
        bb = _spatial_gate(jax.nn.gelu(u_b), jax.nn.gelu(v_b), v_norm_g[l], v_norm_b[l],
                           w_s[l], b_s[l])
        y_a = jnp.einsum('bsc,cd->bsd', a, w_pa[l])
        y_b = jnp.einsum('bsc,cd->bsd', bb, w_pb[l])
        mix = jnp.einsum('bsd,de->bse', g_a * y_a + g_b * y_b, w_o[l])
        x = _layernorm(ALPHA * x + mix, ln1_g[l], ln1_b[l])
        hid = jnp.square(jax.nn.relu(jnp.einsum('bsd,df->bsf', x, w_ff1[l])))
        ffn = jnp.einsum('bsf,fd->bsd', hid, w_ff2[l])
        x = _layernorm(ALPHA * x + ffn, ln2_g[l], ln2_b[l])
    return x
```

```cpp
#include <hip/hip_runtime.h>
#include <cstdio>
#include <cstdint>

namespace nv {
constexpr int D = 1024, SEQ = 16384, WA = 1536, WB = 1024, FF = 4096, NP = 8704, CHUNK = 128, HB = 8;
constexpr int OFF_BA = 0, OFF_CA = 1536, OFF_HA = 3072, OFF_UB = 4608, OFF_VB = 5632, OFF_GA = 6656, OFF_GB = 7680;
constexpr float EPS = 1e-5f;
constexpr float ALPHA = 1.189207115002721f;
constexpr int TC = 2048;

__global__ void __launch_bounds__(256) sgemm(const float* __restrict__ A, int lda, const float* __restrict__ B, int ldb, float* __restrict__ C, int ldc, int M, int N, int K) {
    __shared__ float As[16][64 + 4];
    __shared__ float Bs[16][64];
    const int tid = threadIdx.x, tx = tid & 15, ty = tid >> 4;
    const int m0 = blockIdx.y * 64, n0 = blockIdx.x * 64;
    float acc[4][4];
#pragma unroll
    for (int i = 0; i < 4; ++i)
#pragma unroll
        for (int j = 0; j < 4; ++j) acc[i][j] = 0.f;
    const int ar = tid >> 2, ak = (tid & 3) * 4;
    const int bk = tid >> 4, bn = (tid & 15) * 4;
    for (int k0 = 0; k0 < K; k0 += 16) {
        float4 av = make_float4(0.f, 0.f, 0.f, 0.f);
        if (m0 + ar < M) av = *(const float4*)(A + (size_t)(m0 + ar) * lda + k0 + ak);
        const float4 bv = *(const float4*)(B + (size_t)(k0 + bk) * ldb + n0 + bn);
        As[ak + 0][ar] = av.x; As[ak + 1][ar] = av.y; As[ak + 2][ar] = av.z; As[ak + 3][ar] = av.w;
        *(float4*)&Bs[bk][bn] = bv;
        __syncthreads();
#pragma unroll
        for (int k = 0; k < 16; ++k) {
            float a[4], b[4];
#pragma unroll
            for (int i = 0; i < 4; ++i) a[i] = As[k][ty * 4 + i];
#pragma unroll
            for (int j = 0; j < 4; ++j) b[j] = Bs[k][tx * 4 + j];
#pragma unroll
            for (int i = 0; i < 4; ++i)
#pragma unroll
                for (int j = 0; j < 4; ++j) acc[i][j] = fmaf(a[i], b[j], acc[i][j]);
        }
        __syncthreads();
    }
#pragma unroll
    for (int i = 0; i < 4; ++i) {
        const int r = m0 + ty * 4 + i;
        if (r < M) *(float4*)(C + (size_t)r * ldc + n0 + tx * 4) = make_float4(acc[i][0], acc[i][1], acc[i][2], acc[i][3]);
    }
}

__device__ __forceinline__ float gelu_tanh(float x) {
    const float c = 0.7978845608028654f;
    return 0.5f * x * (1.f + tanhf(c * (x + 0.044715f * x * x * x)));
}
__device__ __forceinline__ float sigm(float x) { return 1.f / (1.f + expf(-x)); }

__global__ void mixer_a(const float* __restrict__ P, int tbase, int t0, int T, const float* __restrict__ cw, float* __restrict__ Aout) {
    const size_t idx = (size_t)blockIdx.x * blockDim.x + threadIdx.x;
    if (idx >= (size_t)T * WA) return;
    const int tl = (int)(idx / WA), c = (int)(idx % WA), t = t0 + tl;
    const float* pr = P + (size_t)(t - tbase) * NP;
    float ch0 = 0.f, ch2 = 0.f;
    const float ch1 = pr[OFF_CA + c] * pr[OFF_HA + c];
    if (t - 1 >= 0) ch0 = pr[-NP + OFF_CA + c] * pr[-NP + OFF_HA + c];
    if (t + 1 < SEQ) ch2 = pr[NP + OFF_CA + c] * pr[NP + OFF_HA + c];
    Aout[idx] = pr[OFF_BA + c] * (cw[c] * ch0 + cw[WA + c] * ch1 + cw[2 * WA + c] * ch2);
}

__global__ void __launch_bounds__(256) vnorm(const float* __restrict__ P, int tbase, int t0, const float* __restrict__ g, const float* __restrict__ b, float* __restrict__ VN) {
    __shared__ float red[256];
    const int tl = blockIdx.x, t = t0 + tl, tid = threadIdx.x;
    const float* pr = P + (size_t)(t - tbase) * NP + OFF_VB;
    float v[4]; float s = 0.f;
#pragma unroll
    for (int j = 0; j < 4; ++j) { v[j] = gelu_tanh(pr[tid + 256 * j]); s += v[j]; }
    red[tid] = s; __syncthreads();
    for (int o = 128; o > 0; o >>= 1) { if (tid < o) red[tid] += red[tid + o]; __syncthreads(); }
    const float mean = red[0] / 1024.f; __syncthreads();
    float q = 0.f;
#pragma unroll
    for (int j = 0; j < 4; ++j) { const float d = v[j] - mean; q += d * d; }
    red[tid] = q; __syncthreads();
    for (int o = 128; o > 0; o >>= 1) { if (tid < o) red[tid] += red[tid + o]; __syncthreads(); }
    const float rstd = rsqrtf(red[0] / 1024.f + EPS);
#pragma unroll
    for (int j = 0; j < 4; ++j) { const int c = tid + 256 * j; VN[(size_t)tl * WB + c] = (v[j] - mean) * rstd * g[c] + b[c]; }
}

__global__ void mixer_b(const float* __restrict__ P, int tbase, int t0, int T, const float* __restrict__ VN, const float* __restrict__ ws, const float* __restrict__ bs, float* __restrict__ BB) {
    const size_t idx = (size_t)blockIdx.x * blockDim.x + threadIdx.x;
    if (idx >= (size_t)T * WB) return;
    const int tl = (int)(idx / WB), c = (int)(idx % WB), h = c / 128, i = tl % CHUNK, cl = tl - i;
    const float* w = ws + ((size_t)h * CHUNK + i) * CHUNK;
    float s = 0.f;
    for (int j = 0; j < CHUNK; ++j) s = fmaf(w[j], VN[(size_t)(cl + j) * WB + c], s);
    s += bs[h * CHUNK + i];
    const float u = P[(size_t)(t0 + tl - tbase) * NP + OFF_UB + c];
    BB[idx] = gelu_tanh(u) * s;
}

__global__ void gate_mix(const float* __restrict__ P, int tbase, int t0, int T, const float* __restrict__ bg, const float* __restrict__ YA, const float* __restrict__ YB, float* __restrict__ Y) {
    const size_t idx = (size_t)blockIdx.x * blockDim.x + threadIdx.x;
    if (idx >= (size_t)T * D) return;
    const int tl = (int)(idx / D), c = (int)(idx % D);
    const float* pr = P + (size_t)(t0 + tl - tbase) * NP;
    Y[idx] = sigm(pr[OFF_GA + c] + bg[c]) * YA[idx] + sigm(pr[OFF_GB + c] + bg[D + c]) * YB[idx];
}

__global__ void __launch_bounds__(256) res_ln(const float* __restrict__ base, const float* __restrict__ add, const float* __restrict__ g, const float* __restrict__ b, float* __restrict__ out) {
    __shared__ float red[256];
    const int tl = blockIdx.x, tid = threadIdx.x;
    float v[4]; float s = 0.f;
#pragma unroll
    for (int j = 0; j < 4; ++j) { const size_t o = (size_t)tl * D + tid + 256 * j; v[j] = ALPHA * base[o] + add[o]; s += v[j]; }
    red[tid] = s; __syncthreads();
    for (int o = 128; o > 0; o >>= 1) { if (tid < o) red[tid] += red[tid + o]; __syncthreads(); }
    const float mean = red[0] / 1024.f; __syncthreads();
    float q = 0.f;
#pragma unroll
    for (int j = 0; j < 4; ++j) { const float d = v[j] - mean; q += d * d; }
    red[tid] = q; __syncthreads();
    for (int o = 128; o > 0; o >>= 1) { if (tid < o) red[tid] += red[tid + o]; __syncthreads(); }
    const float rstd = rsqrtf(red[0] / 1024.f + EPS);
#pragma unroll
    for (int j = 0; j < 4; ++j) { const int c = tid + 256 * j; out[(size_t)tl * D + c] = (v[j] - mean) * rstd * g[c] + b[c]; }
}

__global__ void relu_sq(float* __restrict__ H, size_t n) {
    const size_t idx = (size_t)blockIdx.x * blockDim.x + threadIdx.x;
    if (idx < n) { const float v = fmaxf(H[idx], 0.f); H[idx] = v * v; }
}

inline void gemm(const float* A, int lda, const float* B, int ldb, float* C, int ldc, int M, int N, int K, hipStream_t s) {
    dim3 grid(N / 64, (M + 63) / 64);
    hipLaunchKernelGGL(sgemm, grid, dim3(256), 0, s, A, lda, B, ldb, C, ldc, M, N, K);
}

inline void forward(void* const* d_in, float* out, void* d_ws, hipStream_t s) {
    const float* x = (const float*)d_in[0]; const float* w_in = (const float*)d_in[1]; const float* b_gate = (const float*)d_in[2];
    const float* conv_w = (const float*)d_in[3]; const float* vg = (const float*)d_in[4]; const float* vb = (const float*)d_in[5];
    const float* w_s = (const float*)d_in[6]; const float* b_s = (const float*)d_in[7]; const float* w_pa = (const float*)d_in[8];
    const float* w_pb = (const float*)d_in[9]; const float* w_o = (const float*)d_in[10]; const float* ln1g = (const float*)d_in[11];
    const float* ln1b = (const float*)d_in[12]; const float* w_ff1 = (const float*)d_in[13]; const float* w_ff2 = (const float*)d_in[14];
    const float* ln2g = (const float*)d_in[15]; const float* ln2b = (const float*)d_in[16];
    float* ws = (float*)d_ws;
    float* P = ws;
    float* Abuf = P + (size_t)(TC + 2) * NP;
    float* VN = Abuf + (size_t)TC * WA;
    float* BBuf = VN + (size_t)TC * WB;
    float* YA = BBuf + (size_t)TC * WB;
    float* YB = YA + (size_t)TC * D;
    float* Y = YB + (size_t)TC * D;
    float* MIX = Y + (size_t)TC * D;
    float* X1 = MIX + (size_t)TC * D;
    float* Hh = X1 + (size_t)TC * D;
    float* FFN = Hh + (size_t)TC * FF;
    for (int t0 = 0; t0 < SEQ; t0 += TC) {
        const int tb = t0 > 0 ? t0 - 1 : 0, te = (t0 + TC < SEQ) ? t0 + TC + 1 : SEQ, rows = te - tb;
        gemm(x + (size_t)tb * D, D, w_in, NP, P, NP, rows, NP, D, s);
        hipLaunchKernelGGL(mixer_a, dim3((TC * WA + 255) / 256), dim3(256), 0, s, P, tb, t0, TC, conv_w, Abuf);
        hipLaunchKernelGGL(vnorm, dim3(TC), dim3(256), 0, s, P, tb, t0, vg, vb, VN);
        hipLaunchKernelGGL(mixer_b, dim3((TC * WB + 255) / 256), dim3(256), 0, s, P, tb, t0, TC, VN, w_s, b_s, BBuf);
        gemm(Abuf, WA, w_pa, D, YA, D, TC, D, WA, s);
        gemm(BBuf, WB, w_pb, D, YB, D, TC, D, WB, s);
        hipLaunchKernelGGL(gate_mix, dim3((TC * D + 255) / 256), dim3(256), 0, s, P, tb, t0, TC, b_gate, YA, YB, Y);
        gemm(Y, D, w_o, D, MIX, D, TC, D, D, s);
        hipLaunchKernelGGL(res_ln, dim3(TC), dim3(256), 0, s, x + (size_t)t0 * D, MIX, ln1g, ln1b, X1);
        gemm(X1, D, w_ff1, FF, Hh, FF, TC, FF, D, s);
        hipLaunchKernelGGL(relu_sq, dim3((unsigned)(((size_t)TC * FF + 255) / 256)), dim3(256), 0, s, Hh, (size_t)TC * FF);
        gemm(Hh, FF, w_ff2, D, FFN, D, TC, D, FF, s);
        hipLaunchKernelGGL(res_ln, dim3(TC), dim3(256), 0, s, X1, FFN, ln2g, ln2b, out + (size_t)t0 * D);
    }
}
}

extern "C" void kernel_launch(void* const* d_in, const int* in_sizes, int n_in, void* d_out, int out_size, void* d_ws, size_t ws_size, hipStream_t stream) {
    nv::forward(d_in, (float*)d_out, d_ws, stream);
}
```
